# Optimizing an MI355X kernel written in HIP

```python
import math
import jax, jax.numpy as jnp
from jax import lax
import numpy as np

D_MODEL = 1024
BATCH = 8
SEQ = 4096
DEPTH = 1
DEC_BATCH = 16
DEC_SEQ = 64
PAST_LEN = 2048

CHUNK = 64
Q_BLOCK = 128
HA = 8
DA = 64
HB = 16
DB = 64
LEFT_CHUNKS = 8
BAND_ROWS = LEFT_CHUNKS * CHUNK
MAX_REL = 128
T5_BUCKETS = 32
T5_MAX_DIST = 128
D_FF = 2816
CONV_W = 3
ALPHA = (2.0 * DEPTH) ** 0.25
BETA = (8.0 * DEPTH) ** -0.25
LN_EPS = 1e-5
RMS_EPS = 1e-5
NEG = -1e30

WA = HA * 2 * DA
WB = HB * DB
N_IN = 3 * WA + 3 * WB + 2 * D_MODEL

kernel_name = "hybrid_diffattn_chunkband_convffn_step"


def layer_norm(x, g, b):
    xf = x.astype(jnp.float32)
    mu = jnp.mean(xf, -1, keepdims=True)
    var = jnp.mean(jnp.square(xf - mu), -1, keepdims=True)
    y = (xf - mu) * lax.rsqrt(var + LN_EPS) * g.astype(jnp.float32) + b.astype(jnp.float32)
    return y.astype(x.dtype)


def head_rmsnorm(o, g):
    of = o.astype(jnp.float32)
    of = of * lax.rsqrt(jnp.mean(of * of, -1, keepdims=True) + RMS_EPS)
    return (of * g.astype(jnp.float32)).astype(o.dtype)


def t5_bucket(rel):
    nb = T5_BUCKETS // 2
    max_exact = nb // 2
    ret = jnp.where(rel > 0, nb, 0)
    n = jnp.abs(rel)
    nf = jnp.maximum(n, 1).astype(jnp.float32)
    large = max_exact + (jnp.log(nf / max_exact) / math.log(T5_MAX_DIST / max_exact)
                         * (nb - max_exact)).astype(jnp.int32)
    large = jnp.minimum(large, nb - 1)
    return ret + jnp.where(n < max_exact, n, large)


def split_proj(x, w_in):
    B, T = x.shape[:2]
    p = jnp.einsum('btd,dn->btn', x, w_in)
    cuts = [WA, 2 * WA, 3 * WA, 3 * WA + WB, 3 * WA + 2 * WB, 3 * WA + 3 * WB, 3 * WA + 3 * WB + D_MODEL]
    qa, ka, va, qb, kb, vb, ga, gb = jnp.split(p, cuts, axis=-1)
    qa = qa.reshape(B, T, HA, 2, DA)
    ka = ka.reshape(B, T, HA, 2, DA)
    va = va.reshape(B, T, HA, 2 * DA)
    qb = qb.reshape(B, T, HB, DB)
    kb = kb.reshape(B, T, HB, DB)
    vb = vb.reshape(B, T, HB, DB)
    return qa, ka, va, qb, kb, vb, ga, gb


def diff_attention(q, k, v, qpos, kpos, lam, t5_table):
    s = jnp.einsum('bqhmd,bkhmd->bhmqk', q, k).astype(jnp.float32) * (DA ** -0.5)
    rel = kpos[None, :] - qpos[:, None]
    bias = jnp.transpose(t5_table[t5_bucket(rel)].astype(jnp.float32), (2, 0, 1))
    mask = (kpos[None, :] // CHUNK) <= (qpos[:, None] // CHUNK)
    s = jnp.where(mask, s + bias[None, :, None], NEG)
    p = jax.nn.softmax(s, axis=-1)
    w = p[:, :, 0] - lam * p[:, :, 1]
    return jnp.einsum('bhqk,bkhe->bqhe', w.astype(v.dtype), v)


def band_attention(q, k, v, qpos, kpos, rel_table):
    s = jnp.einsum('bqhd,bkhd->bhqk', q, k).astype(jnp.float32) * (DB ** -0.5)
    rel = jnp.clip(kpos[None, :] - qpos[:, None], -MAX_REL, MAX_REL) + MAX_REL
    bias = jnp.transpose(rel_table[rel].astype(jnp.float32), (2, 0, 1))
    qc = qpos[:, None] // CHUNK
    kc = kpos[None, :] // CHUNK
    mask = (kpos[None, :] >= 0) & (kc <= qc) & (kc >= qc - LEFT_CHUNKS)
    s = jnp.where(mask, s + bias[None], NEG)
    p = jax.nn.softmax(s, axis=-1)
    return jnp.einsum('bhqk,bkhd->bqhd', p.astype(v.dtype), v)


def prompt_diff(qa, ka, va, lam, t5_table):
    B, S = qa.shape[:2]
    nblk = S // Q_BLOCK
    kpos = jnp.arange(S)
    qblocks = jnp.moveaxis(qa.reshape(B, nblk, Q_BLOCK, HA, 2, DA), 1, 0)

    def one_block(args):
        qblk, i = args
        qpos = i * Q_BLOCK + jnp.arange(Q_BLOCK)
        return diff_attention(qblk, ka, va, qpos, kpos, lam, t5_table)

    o = lax.map(one_block, (qblocks, jnp.arange(nblk)))
    return jnp.moveaxis(o, 0, 1).reshape(B, S, HA, 2 * DA)


def prompt_band(qb, kb, vb, rel_table):
    B, S = qb.shape[:2]
    nc = S // CHUNK
    pad = ((0, 0), (BAND_ROWS, 0), (0, 0), (0, 0))
    kp = jnp.pad(kb, pad)
    vp = jnp.pad(vb, pad)
    qchunks = jnp.moveaxis(qb.reshape(B, nc, CHUNK, HB, DB), 1, 0)

    def one_chunk(args):
        qch, c = args
        start = c * CHUNK
        kband = lax.dynamic_slice_in_dim(kp, start, BAND_ROWS + CHUNK, axis=1)
        vband = lax.dynamic_slice_in_dim(vp, start, BAND_ROWS + CHUNK, axis=1)
        qpos = start + jnp.arange(CHUNK)
        kpos = start - BAND_ROWS + jnp.arange(BAND_ROWS + CHUNK)
        return band_attention(qch, kband, vband, qpos, kpos, rel_table)

    o = lax.map(one_chunk, (qchunks, jnp.arange(nc)))
    return jnp.moveaxis(o, 0, 1).reshape(B, S, HB, DB)


def conv_ffn(h, conv_prev, w_up, w_gate, conv_w, conv_b, w_down):
    T = h.shape[1]
    u = jnp.einsum('btd,df->btf', h, w_up)
    g = jnp.einsum('btd,df->btf', h, w_gate)
    ext = jnp.concatenate([conv_prev.astype(u.dtype), u], axis=1)
    uc = conv_b + ext[:, 0:T] * conv_w[0]
    for j in range(1, CONV_W):
        uc = uc + ext[:, j:j + T] * conv_w[j]
    out = jnp.einsum('btf,fd->btd', jax.nn.gelu(uc) * g, w_down)
    return out, ext[:, -(CONV_W - 1):]


def block_tail(x, oa, ob, ga, gb, conv_prev, lam_init, subln_g, w_pa, w_pb, w_out,
               ln1_g, ln1_b, w_up, w_gate, conv_w, conv_b, w_down, ln2_g, ln2_b):
    B, T = x.shape[:2]
    ya = (head_rmsnorm(oa, subln_g) * (1.0 - lam_init)).reshape(B, T, WA) @ w_pa
    yb = ob.reshape(B, T, WB) @ w_pb
    mixed = (jax.nn.sigmoid(ga) * ya + jax.nn.sigmoid(gb) * yb) @ w_out
    h = layer_norm(ALPHA * x + mixed, ln1_g, ln1_b)
    f, conv_state = conv_ffn(h, conv_prev, w_up, w_gate, conv_w, conv_b, w_down)
    return layer_norm(ALPHA * h + f, ln2_g, ln2_b), conv_state


def setup_inputs(seed: int = 0) -> dict:
    key = jax.random.key(seed)
    ks = jax.random.split(key, 32)
    f32 = jnp.float32
    PB = min(BAND_ROWS, PAST_LEN)
    nrm = lambda k, s: jax.random.normal(k, s, f32)
    col_scale = jnp.concatenate([
        jnp.ones((2 * WA,), f32), jnp.full((WA,), BETA, f32),
        jnp.ones((2 * WB,), f32), jnp.full((WB,), BETA, f32),
        jnp.ones((2 * D_MODEL,), f32)])
    return {
        "x_prompt": nrm(ks[0], (BATCH, SEQ, D_MODEL)),
        "x_sample": nrm(ks[1], (DEC_BATCH, DEC_SEQ, D_MODEL)),
        "cache_a_k": nrm(ks[2], (DEPTH, DEC_BATCH, PAST_LEN, HA, 2, DA)),
        "cache_a_v": nrm(ks[3], (DEPTH, DEC_BATCH, PAST_LEN, HA, 2 * DA)) * BETA,
        "cache_b_k": nrm(ks[4], (DEPTH, DEC_BATCH, PB, HB, DB)),
        "cache_b_v": nrm(ks[5], (DEPTH, DEC_BATCH, PB, HB, DB)) * BETA,
        "cache_conv": nrm(ks[6], (DEPTH, DEC_BATCH, CONV_W - 1, D_FF)) * BETA,
        "t5_table": nrm(ks[7], (T5_BUCKETS, HA)) * 0.5,
        "w_in": nrm(ks[8], (DEPTH, D_MODEL, N_IN)) * (D_MODEL ** -0.5) * col_scale,
        "lambda_q1": nrm(ks[9], (DEPTH, DA)) * 0.1,
        "lambda_k1": nrm(ks[10], (DEPTH, DA)) * 0.1,
        "lambda_q2": nrm(ks[11], (DEPTH, DA)) * 0.1,
        "lambda_k2": nrm(ks[12], (DEPTH, DA)) * 0.1,
        "subln_g": 1.0 + 0.01 * nrm(ks[13], (DEPTH, 2 * DA)),
        "rel_table_b": nrm(ks[14], (DEPTH, 2 * MAX_REL + 1, HB)) * 0.5,
        "w_pa": nrm(ks[15], (DEPTH, WA, D_MODEL)) * (WA ** -0.5) * BETA,
        "w_pb": nrm(ks[16], (DEPTH, WB, D_MODEL)) * (WB ** -0.5) * BETA,
        "w_out": nrm(ks[17], (DEPTH, D_MODEL, D_MODEL)) * (D_MODEL ** -0.5) * BETA,
        "ln1_g": 1.0 + 0.01 * nrm(ks[18], (DEPTH, D_MODEL)),
        "ln1_b": 0.01 * nrm(ks[19], (DEPTH, D_MODEL)),
        "w_up": nrm(ks[20], (DEPTH, D_MODEL, D_FF)) * (D_MODEL ** -0.5) * BETA,
        "w_gate": nrm(ks[21], (DEPTH, D_MODEL, D_FF)) * (D_MODEL ** -0.5),
        "conv_w": nrm(ks[22], (DEPTH, CONV_W, D_FF)) * (CONV_W ** -0.5),
        "conv_b": 0.01 * nrm(ks[23], (DEPTH, D_FF)),
        "w_down": nrm(ks[24], (DEPTH, D_FF, D_MODEL)) * (D_FF ** -0.5) * BETA,
        "ln2_g": 1.0 + 0.01 * nrm(ks[25], (DEPTH, D_MODEL)),
        "ln2_b": 0.01 * nrm(ks[26], (DEPTH, D_MODEL)),
    }


def reference(x_prompt, x_sample, cache_a_k, cache_a_v, cache_b_k, cache_b_v, cache_conv,
              t5_table, w_in, lambda_q1, lambda_k1, lambda_q2, lambda_k2, subln_g, rel_table_b,
              w_pa, w_pb, w_out, ln1_g, ln1_b, w_up, w_gate, conv_w, conv_b, w_down, ln2_g, ln2_b):
    f32 = jnp.float32
    xp, xs = x_prompt, x_sample
    S = xp.shape[1]
    T = xs.shape[1]
    pa_k, pa_v, pb_k, pb_v, p_conv = [], [], [], [], []
    sa_k, sa_v, sb_k, sb_v, s_conv = [], [], [], [], []
    for l in range(DEPTH):
        lam_init = 0.8 - 0.6 * math.exp(-0.3 * l)
        lam = (jnp.exp(jnp.sum(lambda_q1[l].astype(f32) * lambda_k1[l].astype(f32)))
               - jnp.exp(jnp.sum(lambda_q2[l].astype(f32) * lambda_k2[l].astype(f32))) + lam_init)
        tail_w = (lam_init, subln_g[l], w_pa[l], w_pb[l], w_out[l], ln1_g[l], ln1_b[l],
                  w_up[l], w_gate[l], conv_w[l], conv_b[l], w_down[l], ln2_g[l], ln2_b[l])

        qa, ka, va, qb, kb, vb, ga, gb = split_proj(xp, w_in[l])
        oa = prompt_diff(qa, ka, va, lam, t5_table)
        ob = prompt_band(qb, kb, vb, rel_table_b[l])
        conv0 = jnp.zeros((xp.shape[0], CONV_W - 1, D_FF), xp.dtype)
        xp, conv_p = block_tail(xp, oa, ob, ga, gb, conv0, *tail_w)
        keep = min(BAND_ROWS, S)
        pa_k.append(ka)
        pa_v.append(va)
        pb_k.append(kb[:, S - keep:])
        pb_v.append(vb[:, S - keep:])
        p_conv.append(conv_p)

        P = cache_a_k.shape[2]
        PB = cache_b_k.shape[2]
        qa, ka, va, qb, kb, vb, ga, gb = split_proj(xs, w_in[l])
        qpos = P + jnp.arange(T)
        ka_all = jnp.concatenate([cache_a_k[l].astype(ka.dtype), ka], axis=1)
        va_all = jnp.concatenate([cache_a_v[l].astype(va.dtype), va], axis=1)
        oa = diff_attention(qa, ka_all, va_all, qpos, jnp.arange(P + T), lam, t5_table)
        kb_all = jnp.concatenate([cache_b_k[l].astype(kb.dtype), kb], axis=1)
        vb_all = jnp.concatenate([cache_b_v[l].astype(vb.dtype), vb], axis=1)
        kpos_b = jnp.concatenate([jnp.arange(P - PB, P), P + jnp.arange(T)])
        ob = band_attention(qb, kb_all, vb_all, qpos, kpos_b, rel_table_b[l])
        xs, conv_s = block_tail(xs, oa, ob, ga, gb, cache_conv[l], *tail_w)
        sa_k.append(ka)
        sa_v.append(va)
        sb_k.append(kb)
        sb_v.append(vb)
        s_conv.append(conv_s)

    return (xp, xs,
            jnp.stack(pa_k), jnp.stack(pa_v), jnp.stack(pb_k), jnp.stack(pb_v), jnp.stack(p_conv),
            jnp.stack(sa_k), jnp.stack(sa_v), jnp.stack(sb_k), jnp.stack(sb_v), jnp.stack(s_conv))
```

```cpp
#include <hip/hip_runtime.h>
#include <hip/hip_cooperative_groups.h>
#include <cstdio>
#include <cstdint>
namespace cg = cooperative_groups;
namespace pg8 {
#define PG8_LAS __attribute__((address_space(3)))
typedef unsigned short bf16_t;
typedef short bf16x8 __attribute__((ext_vector_type(8)));
typedef float f32x4 __attribute__((ext_vector_type(4)));
typedef unsigned u32x4 __attribute__((ext_vector_type(4)));
constexpr int BM = 256, BK = 64, HALF = 128, HTB = HALF * BK * 2  , STAGE_BYTES = 8 * HTB, NXCD = 8, WGM = 8;

__host__ __device__ __forceinline__ int lds_byte(int r, int c) { const int st = (r >> 4) * 2 + (c >> 5), rr = r & 15, cc = c & 31, ob = rr * 64 + cc * 2; return st * 1024 + (ob ^ (((ob >> 9) & 1) << 5)); }
__host__ __device__ __forceinline__ void stage_rc(int b, int& R, int& C) { const int st = b / 1024, sb = b % 1024, swz = sb ^ (((sb >> 9) & 1) << 5); R = (st >> 1) * 16 + swz / 64; C = (st & 1) * 32 + (swz % 64) / 2; }
__host__ __device__ __forceinline__ int perm32(int rho) { const int n = rho >> 4, i = rho & 15; return 8 * (i >> 2) + 4 * n + (i & 3); }

struct Unit { int pm, pn, sel; };
struct Gemm { const bf16_t *A0, *A1, *B0, *B1; int K; };

struct StaticOrder {
    int nM, nN, nwg, G, c;
    __host__ __device__ void init(int M, int N, int G_, int c_) { nM = M / BM; nN = N / BM; nwg = nM * nN; G = G_; c = c_; }
    __host__ __device__ bool next(int i, Unit& u) const {
        const long L = (long)i * G + c; if (L >= nwg) return false;
        int wgid = (int)L; { const int q = nwg / NXCD, r = nwg % NXCD, xcd = wgid % NXCD, off = wgid / NXCD; wgid = (xcd < r ? xcd * (q + 1) : r * (q + 1) + (xcd - r) * q) + off; }
        const int nig = WGM * nN, gid = wgid / nig, fm = gid * WGM, gsz = (nM - fm) < WGM ? (nM - fm) : WGM;
        u.pm = fm + ((wgid % nig) % gsz); u.pn = (wgid % nig) / gsz; u.sel = 0; return true;
    }
    __device__ __forceinline__ void a_ready(const Unit&) const {}
    __device__ __forceinline__ void done(const Unit&) const {}
};

__device__ __forceinline__ unsigned cvt_pk_bf16(float lo, float hi) { unsigned r; asm volatile("v_cvt_pk_bf16_f32 %0, %1, %2" : "=v"(r) : "v"(lo), "v"(hi)); return r; }
typedef float f32x2 __attribute__((ext_vector_type(2)));
template <class Epi, class Sched, bool ALIGN_EPI = false, bool SP2 = false>
__device__ __forceinline__ void gemm_phase(PG8_LAS unsigned char* lds, const Gemm g, const Sched& S, const Epi& E) {
    const int tid = threadIdx.x, wid = __builtin_amdgcn_readfirstlane(tid >> 6), lane = tid & 63, wr = wid >> 2, wc = wid & 3, fr = lane & 15, fq = lane >> 4;
    const int K = g.K, nt = K / BK;
    unsigned voffA[2], voffB[2];
#pragma unroll
    for (int i = 0; i < 2; ++i) { int R, C; stage_rc(tid * 16 + i * 8192, R, C); const int Rb = Epi::PERM ? ((R & ~31) + perm32(R & 31)) : R;
        voffA[i] = (unsigned)(R * K + C) * 2u; voffB[i] = (unsigned)(Rb * K + C) * 2u; }
    const size_t kstep = (size_t)(BK * 2);
    const size_t hstep = (size_t)HALF * K * 2;
    const size_t tstep = 2 * hstep;
    const unsigned ldsw = (unsigned)wid * 1024u;
    const int aoff = lds_byte(wr * 64 + fr, fq * 8), boff = lds_byte(wc * 32 + fr, fq * 8);
#define PG8_SA(b, h) (((b) * 2 + (h)) * HTB)
#define PG8_SB(b, h) ((4 + (b) * 2 + (h)) * HTB)
#define PG8_STAGE(bufoff, gbase, voff) do { _Pragma("unroll") for (int _i = 0; _i < 2; ++_i) \
        __builtin_amdgcn_global_load_lds((const unsigned*)((const char*)(gbase) + (voff)[_i]), (PG8_LAS unsigned*)(lds + (bufoff) + ldsw + _i * 8192), 16, 0, 0); } while (0)
#define PG8_LDA(dst, b, h) do { _Pragma("unroll") for (int m = 0; m < 4; ++m) _Pragma("unroll") for (int k = 0; k < 2; ++k) dst[m][k] = *(const PG8_LAS bf16x8*)(lds + PG8_SA(b, h) + aoff + m * 2048 + k * 1024); } while (0)
#define PG8_LDB(dst, b, h) do { _Pragma("unroll") for (int n = 0; n < 2; ++n) _Pragma("unroll") for (int k = 0; k < 2; ++k) dst[n][k] = *(const PG8_LAS bf16x8*)(lds + PG8_SB(b, h) + boff + n * 2048 + k * 1024); } while (0)
#define PG8_MMA(ai, bj, At, Bt) do { __builtin_amdgcn_s_setprio(1); _Pragma("unroll") for (int m = 0; m < 4; ++m) _Pragma("unroll") for (int n = 0; n < 2; ++n) _Pragma("unroll") for (int k = 0; k < 2; ++k) \
        acc[ai][bj][m][n] = __builtin_amdgcn_mfma_f32_16x16x32_bf16(Bt[n][k], At[m][k], acc[ai][bj][m][n], 0, 0, 0); __builtin_amdgcn_s_setprio(0); } while (0)
#define PG8_WAIT_V(n) asm volatile("s_waitcnt vmcnt(" #n ")" ::: "memory")
#define PG8_WAIT_L(n) asm volatile("s_waitcnt lgkmcnt(" #n ")" ::: "memory")
#define PG8_BAR __builtin_amdgcn_s_barrier()
#define PG8_SCHED __builtin_amdgcn_sched_barrier(0)
    Unit cur, nxt; int ui = 0;
    if (!S.next(0, cur)) return;
    f32x4 acc[2][2][4][2];
#pragma unroll
    for (int a = 0; a < 2; ++a)
#pragma unroll
        for (int b = 0; b < 2; ++b)
#pragma unroll
            for (int m = 0; m < 4; ++m)
#pragma unroll
                for (int n = 0; n < 2; ++n) acc[a][b][m][n] = (f32x4){0.f, 0.f, 0.f, 0.f};
    bf16x8 At[4][2], B0[2][2], B1[2][2];
    const char* cA = (const char*)(cur.sel ? g.A1 : g.A0) + (size_t)cur.pm * tstep; const char* cB = (const char*)(cur.sel ? g.B1 : g.B0) + (size_t)cur.pn * tstep;
    S.a_ready(cur);
    if constexpr (SP2) {
        PG8_STAGE(PG8_SB(0, 0), cB, voffB); PG8_STAGE(PG8_SB(0, 1), cB + hstep, voffB); PG8_STAGE(PG8_SA(0, 0), cA, voffA); PG8_STAGE(PG8_SA(0, 1), cA + hstep, voffA);
        if (wr == 1) PG8_BAR;
        PG8_WAIT_V(2); PG8_BAR;
        PG8_STAGE(PG8_SB(1, 0), cB + kstep, voffB); PG8_STAGE(PG8_SA(1, 0), cA + kstep, voffA); PG8_STAGE(PG8_SB(1, 1), cB + hstep + kstep, voffB);
        PG8_WAIT_V(6); PG8_BAR;
    } else {
        PG8_STAGE(PG8_SB(0, 0), cB, voffB); PG8_STAGE(PG8_SA(0, 0), cA, voffA); PG8_STAGE(PG8_SB(0, 1), cB + hstep, voffB); PG8_STAGE(PG8_SA(0, 1), cA + hstep, voffA);
        if (wr == 1) PG8_BAR;
        PG8_WAIT_V(4); PG8_BAR;
        PG8_STAGE(PG8_SB(1, 0), cB + kstep, voffB); PG8_STAGE(PG8_SA(1, 0), cA + kstep, voffA); PG8_STAGE(PG8_SB(1, 1), cB + hstep + kstep, voffB);
        PG8_WAIT_V(6); PG8_BAR;
    }
    for (;;) {
        const bool has_next = S.next(ui + 1, nxt);
        const char* nA = has_next ? (const char*)(nxt.sel ? g.A1 : g.A0) + (size_t)nxt.pm * tstep : cA; const char* nB = has_next ? (const char*)(nxt.sel ? g.B1 : g.B0) + (size_t)nxt.pn * tstep : cB;
        for (int t = 0; t < nt; t += 2) {
            const bool last = (t == nt - 2);
            const char* a1 = cA + (size_t)(t + 1) * kstep;
            const char* a2 = last ? nA : cA + (size_t)(t + 2) * kstep; const char* b2 = last ? nB : cB + (size_t)(t + 2) * kstep;
            const char* a3 = a2 + kstep; const char* b3 = b2 + kstep;
            if (last && has_next) S.a_ready(nxt);
            if constexpr (SP2) {
            PG8_LDB(B0, 0, 0); PG8_LDB(B1, 0, 1); PG8_SCHED; PG8_LDA(At, 0, 0); PG8_STAGE(PG8_SA(1, 1), a1 + hstep, voffA);
            PG8_WAIT_V(8); PG8_WAIT_L(0); PG8_BAR; PG8_MMA(0, 0, At, B0); PG8_MMA(0, 1, At, B1); PG8_BAR; PG8_SCHED;
            PG8_LDA(At, 0, 1); PG8_STAGE(PG8_SB(0, 0), b2, voffB); PG8_STAGE(PG8_SB(0, 1), b2 + hstep, voffB); PG8_STAGE(PG8_SA(0, 0), a2, voffA);
            PG8_WAIT_V(8); PG8_WAIT_L(0); PG8_BAR; PG8_MMA(1, 0, At, B0); PG8_MMA(1, 1, At, B1); PG8_BAR; PG8_SCHED;
            PG8_LDB(B0, 1, 0); PG8_LDB(B1, 1, 1); PG8_SCHED; PG8_LDA(At, 1, 0); PG8_STAGE(PG8_SA(0, 1), a2 + hstep, voffA);
            PG8_WAIT_V(8); PG8_WAIT_L(0); PG8_BAR; PG8_MMA(0, 0, At, B0); PG8_MMA(0, 1, At, B1); PG8_BAR; PG8_SCHED;
            PG8_LDA(At, 1, 1); PG8_STAGE(PG8_SB(1, 0), b3, voffB); PG8_STAGE(PG8_SB(1, 1), b3 + hstep, voffB); PG8_STAGE(PG8_SA(1, 0), a3, voffA);
            PG8_WAIT_V(8); PG8_WAIT_L(0); PG8_BAR; PG8_MMA(1, 0, At, B0); PG8_MMA(1, 1, At, B1); PG8_BAR; PG8_SCHED;
            } else {
            PG8_LDB(B0, 0, 0); PG8_SCHED; PG8_LDA(At, 0, 0); PG8_STAGE(PG8_SA(1, 1), a1 + hstep, voffA);
            PG8_WAIT_L(8); PG8_BAR; PG8_WAIT_L(0); PG8_MMA(0, 0, At, B0); PG8_BAR; PG8_SCHED;
            PG8_LDB(B1, 0, 1); PG8_STAGE(PG8_SB(0, 0), b2, voffB);
            PG8_BAR; PG8_WAIT_L(0); PG8_MMA(0, 1, At, B1); PG8_BAR;
            PG8_LDA(At, 0, 1); PG8_STAGE(PG8_SA(0, 0), a2, voffA);
            PG8_BAR; PG8_WAIT_L(0); PG8_MMA(1, 0, At, B0); PG8_BAR; PG8_SCHED;
            PG8_STAGE(PG8_SB(0, 1), b2 + hstep, voffB);
            PG8_WAIT_V(6); PG8_BAR; PG8_MMA(1, 1, At, B1); PG8_BAR;
            PG8_LDB(B0, 1, 0); PG8_SCHED; PG8_LDA(At, 1, 0); PG8_STAGE(PG8_SA(0, 1), a2 + hstep, voffA);
            PG8_WAIT_L(8); PG8_BAR; PG8_WAIT_L(0); PG8_MMA(0, 0, At, B0); PG8_BAR; PG8_SCHED;
            PG8_LDB(B1, 1, 1); PG8_STAGE(PG8_SB(1, 0), b3, voffB);
            PG8_BAR; PG8_WAIT_L(0); PG8_MMA(0, 1, At, B1); PG8_BAR;
            PG8_LDA(At, 1, 1); PG8_STAGE(PG8_SA(1, 0), a3, voffA);
            PG8_BAR; PG8_WAIT_L(0); PG8_MMA(1, 0, At, B0); PG8_BAR; PG8_SCHED;
            PG8_STAGE(PG8_SB(1, 1), b3 + hstep, voffB);
            PG8_WAIT_V(6); PG8_BAR; PG8_MMA(1, 1, At, B1); PG8_BAR;
            }
        }
        if constexpr (ALIGN_EPI) { if (wr == 0) PG8_BAR; }
        if constexpr (!Epi::AFTER_DRAIN) { E(acc, cur, wr, wc, fr, fq); S.done(cur); }
        if (!has_next) break;
#pragma unroll
        for (int a = 0; a < 2; ++a)
#pragma unroll
            for (int b = 0; b < 2; ++b)
#pragma unroll
                for (int m = 0; m < 4; ++m)
#pragma unroll
                    for (int n = 0; n < 2; ++n) acc[a][b][m][n] = (f32x4){0.f, 0.f, 0.f, 0.f};
        cur = nxt; cA = nA; cB = nB; ++ui;
        if constexpr (ALIGN_EPI) { if (wr == 1) PG8_BAR; }
    }
    PG8_WAIT_V(0);
    if constexpr (!ALIGN_EPI) { if (wr == 0) PG8_BAR; }
    PG8_BAR;
    if constexpr (Epi::AFTER_DRAIN) { E.fused(acc, cur, wr, wc, fr, fq, lds, wid, lane); S.done(cur); }
#undef PG8_SA
#undef PG8_SB
#undef PG8_STAGE
#undef PG8_LDA
#undef PG8_LDB
#undef PG8_MMA
#undef PG8_WAIT_V
#undef PG8_WAIT_L
#undef PG8_BAR
#undef PG8_SCHED
}
}

#define LAS __attribute__((address_space(3)))
typedef unsigned short bf16_t;
typedef short bf16x8 __attribute__((ext_vector_type(8)));
typedef short s16x4 __attribute__((ext_vector_type(4)));
typedef float f32x4 __attribute__((ext_vector_type(4)));
typedef float f32x2 __attribute__((ext_vector_type(2)));
typedef float f32x16 __attribute__((ext_vector_type(16)));
typedef unsigned u32x4 __attribute__((ext_vector_type(4)));
typedef unsigned u32x2 __attribute__((ext_vector_type(2)));

constexpr int MP = 32768, MS = 1024, MT = 33792, DM = 1024, NIN = 8192, DFF = 2816, NUG = 5632;
constexpr float LOG2E = 1.4426950408889634f;
constexpr float C2 = 0.125f * LOG2E;
constexpr float ALPHA = 1.189207115002721f;
constexpr float LN_EPS = 1e-5f, RMS_EPS = 1e-5f;
constexpr float ONE_M_LAMINIT = 0.8f, LAM_INIT = 0.2f;

constexpr size_t O_Y_P = 0, O_Y_S = 33554432, O_AK_P = 34603008, O_AV_P = 68157440, O_BK_P = 101711872, O_BV_P = 105906176, O_CONV_P = 110100480,
                 O_AK_S = 110145536, O_AV_S = 111194112, O_BK_S = 112242688, O_BV_S = 113291264, O_CONV_S = 114339840, O_TOTAL = 114429952;
constexpr size_t MiB = (size_t)1 << 20;
constexpr size_t WS_WIN = 1 * MiB, WS_WPA = 17 * MiB, WS_WPB = 19 * MiB, WS_WOUT = 21 * MiB, WS_WUG = 23 * MiB, WS_WDN = 34 * MiB, WS_SMALL = 40 * MiB, WS_STATZ = 41 * MiB,
                 WS_GS = 45 * MiB, WS_ZS = 49 * MiB, REGB = 66 * MiB, WS_QA = 56 * MiB, WS_KA = 122 * MiB, WS_VA = 188 * MiB, WS_QB = 254 * MiB, WS_KB = 320 * MiB, WS_VB = 386 * MiB,
                 WS_XB = 452 * MiB, WS_END = 518 * MiB;
constexpr size_t WS_TMP = WS_KA, WS_MRG = WS_VA, WS_ZB = WS_XB, WS_U = WS_QB, WS_ACT = WS_QA;
constexpr size_t SM_LAM = 0, SM_BTAB = 1024, SM_CS = 32768, SM_BW = 57344, SM_PCS = 131072, SM_PBW = 524288;
constexpr int RING_BYTES = 131072, PT_OFF = 131072 + 1024, LDS_BYTES = 147456;

#define LDS_WAIT() asm volatile("s_waitcnt lgkmcnt(0)" ::: "memory")
#define VM_WAIT() asm volatile("s_waitcnt vmcnt(0)" ::: "memory")
#define WG_BAR() do { asm volatile("s_waitcnt lgkmcnt(0)" ::: "memory"); __builtin_amdgcn_s_barrier(); asm volatile("" ::: "memory"); } while (0)

__device__ __forceinline__ unsigned f2bf(float f) { unsigned u = __builtin_bit_cast(unsigned, f); return (u + 0x7fffu + ((u >> 16) & 1u)) >> 16; }
__device__ __forceinline__ unsigned pk2(float lo, float hi) { return f2bf(lo) | (f2bf(hi) << 16); }
__device__ __forceinline__ float bfround(float f) { return __builtin_bit_cast(float, f2bf(f) << 16); }
typedef __bf16 bf16x2_t __attribute__((ext_vector_type(2)));
__device__ __forceinline__ unsigned cvtpk(float lo, float hi) { f32x2 v = {lo, hi}; bf16x2_t b = __builtin_convertvector(v, bf16x2_t); return __builtin_bit_cast(unsigned, b); }
__device__ __forceinline__ float bflo(unsigned u) { return __builtin_bit_cast(float, u << 16); }
__device__ __forceinline__ float bfhi(unsigned u) { return __builtin_bit_cast(float, u & 0xffff0000u); }
__device__ __forceinline__ float sigmoidf_(float v) { return __builtin_amdgcn_rcpf(1.f + __builtin_amdgcn_exp2f(-v * LOG2E)); }
__device__ __forceinline__ float gelu_tanh(float x) { const float t = x + 0.044715f * x * x * x; return x * __builtin_amdgcn_rcpf(1.f + __builtin_amdgcn_exp2f(-2.f * 0.7978845608028654f * LOG2E * t)); }
__device__ __forceinline__ float ld_relaxed(const float* p) { return __builtin_bit_cast(float, __hip_atomic_load((const unsigned*)p, __ATOMIC_RELAXED, __HIP_MEMORY_SCOPE_AGENT)); }

struct Args { const float* in[27]; float* out; unsigned char* ws; int ph_lo, ph_hi; };

__device__ __forceinline__ void row_mu_rstd(const float* st8, float& mu, float& rstd) {
    const f32x4 a = *(const f32x4*)st8, b = *(const f32x4*)(st8 + 4);
    mu = (a.x + a.z + b.x + b.z) * 0.25f;
    const float d0 = a.x - mu, d1 = a.z - mu, d2 = b.x - mu, d3 = b.z - mu;
    const float m2 = (a.y + a.w) + (b.y + b.w) + 256.f * ((d0 * d0 + d1 * d1) + (d2 * d2 + d3 * d3));
    rstd = __builtin_amdgcn_rsqf(m2 * (1.f / 1024.f) + LN_EPS);
}

namespace pg8 {
struct EpiInProj {
    static constexpr bool PERM = true, AFTER_DRAIN = false;
    unsigned char* ws; float* out;
    __device__ __forceinline__ void operator()(f32x4 (&acc)[2][2][4][2], const Unit& u, int wr, int wc, int fr, int fq) const {
        const int t = u.pn >> 2, colt = (u.pn & 3) * 256;
        const bool samp = u.pm >= 128;
        const int prow0 = samp ? (u.pm - 128) * 256 : u.pm * 256;
        bf16_t* bbase; float* fbase = nullptr;
        if (t < 6) bbase = (bf16_t*)(ws + WS_QA + (size_t)t * REGB) + (size_t)(u.pm * 256) * 1024;
        else bbase = samp ? (bf16_t*)(ws + WS_GS + (size_t)(t - 6) * (2 * MiB)) + (size_t)prow0 * 1024 : (bf16_t*)out + (size_t)(t - 6) * ((size_t)MP * 1024) + (size_t)prow0 * 1024;
        if (t == 1) fbase = out + (samp ? O_AK_S : O_AK_P) + (size_t)prow0 * 1024;
        else if (t == 2) fbase = out + (samp ? O_AV_S : O_AV_P) + (size_t)prow0 * 1024;
        else if (t == 4 || t == 5) {
            if (samp) fbase = out + (t == 4 ? O_BK_S : O_BV_S) + (size_t)prow0 * 1024;
            else if ((u.pm & 15) >= 14) fbase = out + (t == 4 ? O_BK_P : O_BV_P) + (size_t)((u.pm >> 4) * 512 + ((u.pm & 15) - 14) * 256) * 1024;
        }
        const int lrow0 = wr * 64 + fr, col0 = colt + wc * 32 + 8 * fq;
        const bool gate = t >= 6;
#pragma unroll
        for (int ai = 0; ai < 2; ++ai)
#pragma unroll
            for (int m = 0; m < 4; ++m) { const size_t ro = (size_t)(lrow0 + ai * HALF + m * 16) * 1024 + col0;
#pragma unroll
                for (int bj = 0; bj < 2; ++bj) { f32x4 v0 = acc[ai][bj][m][0], v1 = acc[ai][bj][m][1];
                    if (gate) { v0 = (f32x4){sigmoidf_(v0[0]), sigmoidf_(v0[1]), sigmoidf_(v0[2]), sigmoidf_(v0[3])}; v1 = (f32x4){sigmoidf_(v1[0]), sigmoidf_(v1[1]), sigmoidf_(v1[2]), sigmoidf_(v1[3])}; }
                    u32x4 w; w.x = cvt_pk_bf16(v0[0], v0[1]); w.y = cvt_pk_bf16(v0[2], v0[3]); w.z = cvt_pk_bf16(v1[0], v1[1]); w.w = cvt_pk_bf16(v1[2], v1[3]);
                    *(u32x4*)(bbase + ro + bj * HALF) = w;
                    if (fbase) { *(f32x4*)(fbase + ro + bj * HALF) = v0; *(f32x4*)(fbase + ro + bj * HALF + 4) = v1; } } }
    }
};
struct EpiGate {
    static constexpr bool PERM = true, AFTER_DRAIN = false;
    unsigned char* ws; float* out;
    __device__ __forceinline__ void operator()(f32x4 (&acc)[2][2][4][2], const Unit& u, int wr, int wc, int fr, int fq) const {
        const bool samp = u.pm >= 128; const int sel = u.sel;
        const int prow0 = samp ? (u.pm - 128) * 256 : u.pm * 256;
        const bf16_t* gbase = samp ? (const bf16_t*)(ws + WS_GS + (size_t)sel * (2 * MiB)) + (size_t)prow0 * 1024 : (const bf16_t*)out + (size_t)sel * ((size_t)MP * 1024) + (size_t)prow0 * 1024;
        bf16_t* tmp = (bf16_t*)(ws + WS_TMP) + (size_t)(u.pm * 256) * 1024; bf16_t* mrg = (bf16_t*)(ws + WS_MRG) + (size_t)(u.pm * 256) * 1024;
        const int lrow0 = wr * 64 + fr, col0 = u.pn * 256 + wc * 32 + 8 * fq;
#pragma unroll
        for (int ai = 0; ai < 2; ++ai)
#pragma unroll
            for (int m = 0; m < 4; ++m) { const size_t ro = (size_t)(lrow0 + ai * HALF + m * 16) * 1024 + col0;
#pragma unroll
                for (int bj = 0; bj < 2; ++bj) { const f32x4 v0 = acc[ai][bj][m][0], v1 = acc[ai][bj][m][1];
                    const u32x4 gv = *(const u32x4*)(gbase + ro + bj * HALF);
                    float r0 = bflo(gv.x) * v0[0], r1 = bfhi(gv.x) * v0[1], r2 = bflo(gv.y) * v0[2], r3 = bfhi(gv.y) * v0[3], r4 = bflo(gv.z) * v1[0], r5 = bfhi(gv.z) * v1[1], r6 = bflo(gv.w) * v1[2], r7 = bfhi(gv.w) * v1[3];
                    if (sel == 0) { u32x4 w; w.x = cvt_pk_bf16(r0, r1); w.y = cvt_pk_bf16(r2, r3); w.z = cvt_pk_bf16(r4, r5); w.w = cvt_pk_bf16(r6, r7); *(u32x4*)(tmp + ro + bj * HALF) = w; }
                    else { const u32x4 tv = *(const u32x4*)(tmp + ro + bj * HALF);
                        r0 += bflo(tv.x); r1 += bfhi(tv.x); r2 += bflo(tv.y); r3 += bfhi(tv.y); r4 += bflo(tv.z); r5 += bfhi(tv.z); r6 += bflo(tv.w); r7 += bfhi(tv.w);
                        u32x4 w; w.x = cvt_pk_bf16(r0, r1); w.y = cvt_pk_bf16(r2, r3); w.z = cvt_pk_bf16(r4, r5); w.w = cvt_pk_bf16(r6, r7); *(u32x4*)(mrg + ro + bj * HALF) = w; } } }
    }
};
__device__ __forceinline__ void tile_row_stats(const f32x4 (&v)[2][2][4][2], const Unit& u, int wr, int wc, int fr, int fq, PG8_LAS unsigned char* pt, float* stats) {
    PG8_LAS f32x2* P = (PG8_LAS f32x2*)pt;
#pragma unroll
    for (int ai = 0; ai < 2; ++ai)
#pragma unroll
        for (int m = 0; m < 4; ++m) {
            float s = 0.f;
#pragma unroll
            for (int bj = 0; bj < 2; ++bj)
#pragma unroll
                for (int n = 0; n < 2; ++n) { const f32x4 x = v[ai][bj][m][n]; s += (x[0] + x[1]) + (x[2] + x[3]); }
            s += __shfl_xor(s, 16); s += __shfl_xor(s, 32);
            const float mw = s * (1.0f / 64.0f); float q = 0.f;
#pragma unroll
            for (int bj = 0; bj < 2; ++bj)
#pragma unroll
                for (int n = 0; n < 2; ++n) { const f32x4 d = v[ai][bj][m][n] - mw; q += (d[0] * d[0] + d[1] * d[1]) + (d[2] * d[2] + d[3] * d[3]); }
            q += __shfl_xor(q, 16); q += __shfl_xor(q, 32);
            if (fq == 0) P[(ai * HALF + wr * 64 + m * 16 + fr) * 4 + wc] = (f32x2){mw, q};
        }
    asm volatile("s_waitcnt lgkmcnt(0)" ::: "memory"); __builtin_amdgcn_s_barrier(); asm volatile("" ::: "memory");
    const int tid = threadIdx.x;
    if (tid < 256) { const int row = tid;
        const f32x2 a = P[row * 4 + 0], b = P[row * 4 + 1], c = P[row * 4 + 2], d = P[row * 4 + 3];
        const float mt = (a.x + b.x + c.x + d.x) * 0.25f;
        const float da = a.x - mt, db = b.x - mt, dc = c.x - mt, dd = d.x - mt;
        const float m2 = (a.y + b.y) + (c.y + d.y) + 64.0f * ((da * da + db * db) + (dc * dc + dd * dd));
        *(f32x2*)(stats + ((size_t)(u.pm * 256 + row) * 4 + u.pn) * 2) = (f32x2){mt, m2}; }
    asm volatile("s_waitcnt lgkmcnt(0)" ::: "memory");
}
struct EpiZ {
    static constexpr bool PERM = false, AFTER_DRAIN = false;
    const float* xp; const float* xs; unsigned char* ws; float* out; PG8_LAS unsigned char* pt;
    __device__ __forceinline__ void operator()(f32x4 (&acc)[2][2][4][2], const Unit& u, int wr, int wc, int fr, int fq) const {
        const bool samp = u.pm >= 128; const int prow0 = samp ? (u.pm - 128) * 256 : u.pm * 256;
        const float* xb = (samp ? xs : xp) + (size_t)prow0 * 1024;
        float* z32 = (samp ? (float*)(ws + WS_ZS) : out + O_Y_P) + (size_t)prow0 * 1024;
        bf16_t* z16 = (bf16_t*)(ws + WS_ZB) + (size_t)(u.pm * 256) * 1024;
        const int lrow0 = wr * 64 + fr, col0 = u.pn * 256 + wc * 32 + 4 * fq;
#pragma unroll
        for (int ai = 0; ai < 2; ++ai)
#pragma unroll
            for (int m = 0; m < 4; ++m) { const size_t ro = (size_t)(lrow0 + ai * HALF + m * 16) * 1024 + col0;
#pragma unroll
                for (int bj = 0; bj < 2; ++bj)
#pragma unroll
                    for (int n = 0; n < 2; ++n) { const size_t o = ro + bj * HALF + n * 16; const f32x4 xv = *(const f32x4*)(xb + o);
                        const f32x4 z = xv * ALPHA + acc[ai][bj][m][n]; acc[ai][bj][m][n] = z; *(f32x4*)(z32 + o) = z;
                        u32x2 w; w.x = cvt_pk_bf16(z[0], z[1]); w.y = cvt_pk_bf16(z[2], z[3]); *(u32x2*)(z16 + o) = w; } }
        tile_row_stats(acc, u, wr, wc, fr, fq, pt, (float*)(ws + WS_STATZ));
    }
};
struct EpiUG {
    static constexpr bool PERM = true, AFTER_DRAIN = false;
    unsigned char* ws; float* out;
    __device__ __forceinline__ void operator()(f32x4 (&acc)[2][2][4][2], const Unit& u, int wr, int wc, int fr, int fq) const {
        const bool samp = u.pm >= 128;
        const float* stats = (const float*)(ws + WS_STATZ);
        const float* cs = (const float*)(ws + WS_SMALL + SM_CS); const float* bw = (const float*)(ws + WS_SMALL + SM_BW);
        const int lrow0 = wr * 64 + fr, ncol0 = u.pn * 256 + wc * 32 + 8 * fq, ucol0 = u.pn * 128 + wc * 32 + 8 * fq;
        f32x4 csv[2][2], bwv[2][2];
#pragma unroll
        for (int bj = 0; bj < 2; ++bj)
#pragma unroll
            for (int n = 0; n < 2; ++n) { csv[bj][n] = *(const f32x4*)(cs + ncol0 + bj * HALF + 4 * n); bwv[bj][n] = *(const f32x4*)(bw + ncol0 + bj * HALF + 4 * n); }
        bf16_t* U = (bf16_t*)(ws + WS_U); bf16_t* G = (bf16_t*)(ws + WS_ACT);
#pragma unroll
        for (int ai = 0; ai < 2; ++ai)
#pragma unroll
            for (int m = 0; m < 4; ++m) { const int row = u.pm * 256 + lrow0 + ai * HALF + m * 16;
                float mu, rstd; row_mu_rstd(stats + (size_t)row * 8, mu, rstd);
                const size_t ro = (size_t)row * DFF + ucol0;
                f32x4 u0 = (acc[ai][0][m][0] - csv[0][0] * mu) * rstd + bwv[0][0], u1 = (acc[ai][0][m][1] - csv[0][1] * mu) * rstd + bwv[0][1];
                f32x4 g0 = (acc[ai][1][m][0] - csv[1][0] * mu) * rstd + bwv[1][0], g1 = (acc[ai][1][m][1] - csv[1][1] * mu) * rstd + bwv[1][1];
                u32x4 w; w.x = cvt_pk_bf16(u0[0], u0[1]); w.y = cvt_pk_bf16(u0[2], u0[3]); w.z = cvt_pk_bf16(u1[0], u1[1]); w.w = cvt_pk_bf16(u1[2], u1[3]); *(u32x4*)(U + ro) = w;
                w.x = cvt_pk_bf16(g0[0], g0[1]); w.y = cvt_pk_bf16(g0[2], g0[3]); w.z = cvt_pk_bf16(g1[0], g1[1]); w.w = cvt_pk_bf16(g1[2], g1[3]); *(u32x4*)(G + ro) = w;
                if (m == 3 && fr >= 14) {
                    if (samp) { const int seq = (u.pm - 128) * 4 + ai * 2 + wr; float* d = out + O_CONV_S + (size_t)(seq * 2 + fr - 14) * DFF + ucol0; *(f32x4*)d = u0; *(f32x4*)(d + 4) = u1; }
                    else if ((u.pm & 15) == 15 && ai == 1 && wr == 1) { float* d = out + O_CONV_P + (size_t)((u.pm >> 4) * 2 + fr - 14) * DFF + ucol0; *(f32x4*)d = u0; *(f32x4*)(d + 4) = u1; }
                } }
    }
};
struct EpiW {
    static constexpr bool PERM = false, AFTER_DRAIN = false;
    unsigned char* ws; float* out; const float* g1; const float* b1;
    __device__ __forceinline__ void operator()(f32x4 (&acc)[2][2][4][2], const Unit& u, int wr, int wc, int fr, int fq) const {
        const bool samp = u.pm >= 128; const int prow0 = samp ? (u.pm - 128) * 256 : u.pm * 256;
        float* z32 = (samp ? (float*)(ws + WS_ZS) : out + O_Y_P) + (size_t)prow0 * 1024;
        const float* stats = (const float*)(ws + WS_STATZ);
        const int lrow0 = wr * 64 + fr, col0 = u.pn * 256 + wc * 32 + 4 * fq;
        f32x4 gv[2][2], bv[2][2];
#pragma unroll
        for (int bj = 0; bj < 2; ++bj)
#pragma unroll
            for (int n = 0; n < 2; ++n) { gv[bj][n] = *(const f32x4*)(g1 + col0 + bj * HALF + n * 16); bv[bj][n] = *(const f32x4*)(b1 + col0 + bj * HALF + n * 16); }
#pragma unroll
        for (int ai = 0; ai < 2; ++ai)
#pragma unroll
            for (int m = 0; m < 4; ++m) { const int lrow = lrow0 + ai * HALF + m * 16; const size_t ro = (size_t)lrow * 1024 + col0;
                float mu, rstd; row_mu_rstd(stats + (size_t)(u.pm * 256 + lrow) * 8, mu, rstd);
#pragma unroll
                for (int bj = 0; bj < 2; ++bj)
#pragma unroll
                    for (int n = 0; n < 2; ++n) { const size_t o = ro + bj * HALF + n * 16; const f32x4 z = *(const f32x4*)(z32 + o);
                        const f32x4 h = (z - mu) * rstd * gv[bj][n] + bv[bj][n]; *(f32x4*)(z32 + o) = h * ALPHA + acc[ai][bj][m][n]; } }
    }
};
struct OrderPlain : StaticOrder {};
struct OrderPair : StaticOrder {
    __device__ bool next(int i, Unit& u) const { if (!StaticOrder::next(i >> 1, u)) return false; u.sel = i & 1; return true; }
};
}

namespace att {
constexpr int STAGE = 32768, KOFF = 0, VOFF = 16384, ALPHA_OFF = 65536, TAB_OFF = 66560, OST_OFF = 69632;
constexpr float THR = 3.0f;
__device__ __forceinline__ int crow(int r, int hi) { return (r & 3) + 8 * (r >> 2) + 4 * hi; }
typedef short v4i16_t __attribute__((ext_vector_type(4)));
__device__ __forceinline__ s16x4 vtr(const LAS unsigned char* p) { return __builtin_bit_cast(s16x4, __builtin_amdgcn_ds_read_tr16_b64_v4i16((LAS v4i16_t*)p)); }

struct AttnP {
    const bf16_t *Q, *K, *V; bf16_t* O;
    const float *cK, *cV;
    const float* btab;
    const float* subln; float lam;
};

template <bool ISA>
__device__ __forceinline__ void attn_unit(LAS unsigned char* lds, const AttnP& P, int b, int h, int qb, bool samp) {
    constexpr int NDQ = ISA ? 4 : 2;
    const int tid = threadIdx.x, lane = tid & 63, r32 = lane & 31, hi = lane >> 5;
    const int wid = __builtin_amdgcn_readfirstlane(tid >> 6), g = wid >> 2, lw = wid & 3;
    const bool active = samp ? (lw < 2) : true;
    const int qrow0 = samp ? (MP + b * 64) : (b * 4096 + qb * 128);
    const int cw = samp ? 32 : (2 * qb + (lw >> 1));
    const int jhi = samp ? 32 : (2 * qb + 1);
    const int jlo = ISA ? 0 : (samp ? 24 : (2 * qb - 8 > 0 ? 2 * qb - 8 : 0));
    const int colb = h * 128;
    LAS float* tabs = (LAS float*)(lds + TAB_OFF);
    { const int tg = tid >> 8, ti = tid & 255; const int hh = ISA ? h : 8 + 2 * h + tg; tabs[tid] = P.btab[hh * 256 + ti]; }
    bf16x8 qr[4];
    { const bf16_t* q = P.Q + (size_t)(qrow0 + (active ? 32 * lw : 0) + r32) * 1024 + colb + 64 * g + 8 * hi;
#pragma unroll
      for (int d0 = 0; d0 < 4; ++d0) qr[d0] = *(const bf16x8*)(q + 16 * d0); }
    f32x16 o[NDQ];
#pragma unroll
    for (int i = 0; i < NDQ; ++i) o[i] = (f32x16){0.f, 0.f, 0.f, 0.f, 0.f, 0.f, 0.f, 0.f, 0.f, 0.f, 0.f, 0.f, 0.f, 0.f, 0.f, 0.f};
    float mhat = -1e30f, lsum = 0.f;
    LAS float* aw = (LAS float*)(lds + ALPHA_OFF) + wid * 32;
    const int vb = ((lane >> 4) & 1) * 32 + (lane & 3) * 8 + (4 * hi + ((lane & 15) >> 2)) * 64;
#define ATT_DMA(jc, st) do { const int krow0_ = samp ? (MP + b * 64) : (b * 4096 + 64 * (jc)); \
        const bf16_t* ks_ = P.K + (size_t)(krow0_ + lane) * 1024 + colb + wid * 8; \
        const bf16_t* vs_ = P.V + (size_t)(krow0_ + 16 * (wid & 3) + (lane >> 2)) * 1024 + colb + (wid >> 2) * 32 + (lane & 3) * 8; \
        LAS unsigned char* kd_ = lds + (st) * STAGE + KOFF + wid * 1024; LAS unsigned char* vd_ = lds + (st) * STAGE + VOFF + (wid >> 2) * 4096 + (wid & 3) * 1024; \
        __builtin_amdgcn_global_load_lds((const unsigned*)ks_, (LAS unsigned*)kd_, 16, 0, 0); \
        __builtin_amdgcn_global_load_lds((const unsigned*)(ks_ + 64), (LAS unsigned*)(kd_ + 8192), 16, 0, 0); \
        __builtin_amdgcn_global_load_lds((const unsigned*)vs_, (LAS unsigned*)vd_, 16, 0, 0); \
        __builtin_amdgcn_global_load_lds((const unsigned*)(vs_ + 64), (LAS unsigned*)(vd_ + 8192), 16, 0, 0); } while (0)
#define ATT_F32_SRC(jc, kp_, vp_) do { const size_t off_ = ISA ? ((size_t)(b * 2048 + 64 * (jc)) * 8 + h) * 128 : ((size_t)(b * 512 + 64 * ((jc) - 24)) * 16 + 2 * h) * 64; \
        kp_ = P.cK + off_ + (size_t)(tid >> 4) * 1024 + (tid & 15) * 8; vp_ = P.cV + off_ + (size_t)(tid >> 4) * 1024 + (tid & 15) * 8; } while (0)
#define ATT_F32_LOAD(kp_, vp_) do { sk[0] = *(const f32x4*)(kp_); sk[1] = *(const f32x4*)(kp_ + 4); sk[2] = *(const f32x4*)(kp_ + 32 * 1024); sk[3] = *(const f32x4*)(kp_ + 32 * 1024 + 4); \
        sv[0] = *(const f32x4*)(vp_); sv[1] = *(const f32x4*)(vp_ + 4); sv[2] = *(const f32x4*)(vp_ + 32 * 1024); sv[3] = *(const f32x4*)(vp_ + 32 * 1024 + 4); } while (0)
#define ATT_PK8(a, bb) (u32x4){cvtpk(a[0], a[1]), cvtpk(a[2], a[3]), cvtpk(bb[0], bb[1]), cvtpk(bb[2], bb[3])}
#define ATT_F32_WRITE(st) do { const int row_ = tid >> 4, c8_ = tid & 15; \
        LAS unsigned char* kd_ = lds + (st) * STAGE + KOFF + c8_ * 1024 + row_ * 16; LAS unsigned char* vd_ = lds + (st) * STAGE + VOFF + (c8_ >> 2) * 4096 + row_ * 64 + (c8_ & 3) * 16; \
        *(LAS u32x4*)kd_ = ATT_PK8(sk[0], sk[1]); *(LAS u32x4*)(kd_ + 32 * 16) = ATT_PK8(sk[2], sk[3]); \
        *(LAS u32x4*)vd_ = ATT_PK8(sv[0], sv[1]); *(LAS u32x4*)(vd_ + 32 * 64) = ATT_PK8(sv[2], sv[3]); } while (0)
    f32x4 sk[4], sv[4];
    if (samp && jlo < 32) { const float *kp, *vp; ATT_F32_SRC(jlo, kp, vp); ATT_F32_LOAD(kp, vp); ATT_F32_WRITE(0); }
    else ATT_DMA(jlo, 0);
    VM_WAIT(); __syncthreads();
    for (int j = jlo; j <= jhi; ++j) {
        const int cur = (j - jlo) & 1;
        const bool more = j < jhi;
        const bool nf32 = more && samp && (j + 1 < 32);
        if (more) { if (nf32) { const float *kp, *vp; ATT_F32_SRC(j + 1, kp, vp); ATT_F32_LOAD(kp, vp); } else ATT_DMA(j + 1, cur ^ 1); }
        const int delta = j - cw;
        const bool vis = active && delta <= 0 && (ISA || delta >= -8);
        if (vis) {
            const LAS unsigned char* Kt = lds + cur * STAGE + KOFF; const LAS unsigned char* Vt = lds + cur * STAGE + VOFF;
            f32x16 p0, p1;
            if (delta <= -3) { const float cf = tabs[g * 256 + 255];
#pragma unroll
                for (int r = 0; r < 16; ++r) { p0[r] = cf; p1[r] = cf; } }
            else { const LAS float* tp = tabs + g * 256 + (191 - (32 * (lw & 1) + r32) + 4 * hi + 64 * delta);
#pragma unroll
                for (int r = 0; r < 16; ++r) { p0[r] = tp[(r & 3) + 8 * (r >> 2)]; p1[r] = tp[(r & 3) + 8 * (r >> 2) + 32]; } }
            const LAS unsigned char* kb = Kt + (8 * g + hi) * 1024 + r32 * 16;
#pragma unroll
            for (int d0 = 0; d0 < 4; ++d0) {
                const bf16x8 b0 = *(const LAS bf16x8*)(kb + d0 * 2048), b1 = *(const LAS bf16x8*)(kb + d0 * 2048 + 512);
                p0 = __builtin_amdgcn_mfma_f32_32x32x16_bf16(b0, qr[d0], p0, 0, 0, 0);
                p1 = __builtin_amdgcn_mfma_f32_32x32x16_bf16(b1, qr[d0], p1, 0, 0, 0); }
            float rm = fmaxf(p0[0], p1[0]);
#pragma unroll
            for (int r = 1; r < 16; ++r) rm = fmaxf(rm, fmaxf(p0[r], p1[r]));
            { auto rr = __builtin_amdgcn_permlane32_swap(__builtin_bit_cast(unsigned, rm), __builtin_bit_cast(unsigned, rm), false, false);
              rm = fmaxf(__builtin_bit_cast(float, rr[0]), __builtin_bit_cast(float, rr[1])); }
            if (__any(rm > mhat + THR)) {
                const float mn = fmaxf(mhat, rm), f = __builtin_amdgcn_exp2f(mhat - mn); mhat = mn; lsum *= f;
                if (hi == 0) aw[r32] = f;
                LDS_WAIT();
#pragma unroll
                for (int r = 0; r < 16; ++r) { const float fr_ = aw[crow(r, hi)];
#pragma unroll
                    for (int i = 0; i < NDQ; ++i) o[i][r] *= fr_; }
            }
            float sacc = 0.f;
#pragma unroll
            for (int r = 0; r < 16; ++r) { p0[r] = __builtin_amdgcn_exp2f(p0[r] - mhat); p1[r] = __builtin_amdgcn_exp2f(p1[r] - mhat); sacc += p0[r] + p1[r]; }
            lsum += sacc;
            bf16x8 pa[4];
            pa[0] = __builtin_bit_cast(bf16x8, (u32x4){cvtpk(p0[0], p0[1]), cvtpk(p0[2], p0[3]), cvtpk(p0[4], p0[5]), cvtpk(p0[6], p0[7])});
            pa[1] = __builtin_bit_cast(bf16x8, (u32x4){cvtpk(p0[8], p0[9]), cvtpk(p0[10], p0[11]), cvtpk(p0[12], p0[13]), cvtpk(p0[14], p0[15])});
            pa[2] = __builtin_bit_cast(bf16x8, (u32x4){cvtpk(p1[0], p1[1]), cvtpk(p1[2], p1[3]), cvtpk(p1[4], p1[5]), cvtpk(p1[6], p1[7])});
            pa[3] = __builtin_bit_cast(bf16x8, (u32x4){cvtpk(p1[8], p1[9]), cvtpk(p1[10], p1[11]), cvtpk(p1[12], p1[13]), cvtpk(p1[14], p1[15])});
#pragma unroll
            for (int i = 0; i < NDQ; ++i) { const int dq = ISA ? i : 2 * g + i;
#pragma unroll
                for (int ks = 0; ks < 4; ++ks) { const s16x4 lo = vtr(Vt + vb + dq * 4096 + ks * 1024), hi_ = vtr(Vt + vb + dq * 4096 + ks * 1024 + 512);
                    const bf16x8 vf = (bf16x8){lo[0], lo[1], lo[2], lo[3], hi_[0], hi_[1], hi_[2], hi_[3]};
                    o[i] = __builtin_amdgcn_mfma_f32_32x32x16_bf16(pa[ks], vf, o[i], 0, 0, 0); } }
        }
        if (nf32) ATT_F32_WRITE(cur ^ 1);
        VM_WAIT(); __syncthreads();
    }
    { auto rr = __builtin_amdgcn_permlane32_swap(__builtin_bit_cast(unsigned, lsum), __builtin_bit_cast(unsigned, lsum), false, false);
      lsum = __builtin_bit_cast(float, rr[0]) + __builtin_bit_cast(float, rr[1]); }
    const float inv = active ? __builtin_amdgcn_rcpf(lsum) : 0.f;
    if (hi == 0) aw[r32] = inv;
    LDS_WAIT();
    float rinv[16];
#pragma unroll
    for (int r = 0; r < 16; ++r) rinv[r] = aw[crow(r, hi)];
    if (ISA) {
        LAS float* cmb = (LAS float*)lds;
        if (g == 1 && active) {
#pragma unroll
            for (int i = 0; i < NDQ; ++i)
#pragma unroll
                for (int r = 0; r < 16; ++r) cmb[((lw * 4 + i) * 16 + r) * 64 + lane] = o[i][r] * rinv[r]; }
        LDS_WAIT(); __syncthreads();
        if (g == 0 && active) {
            float ss[16];
#pragma unroll
            for (int r = 0; r < 16; ++r) { float s = 0.f;
#pragma unroll
                for (int i = 0; i < NDQ; ++i) { const float x = o[i][r] * rinv[r] - P.lam * cmb[((lw * 4 + i) * 16 + r) * 64 + lane]; o[i][r] = x; s += x * x; }
                ss[r] = s; }
#pragma unroll
            for (int mk = 1; mk < 32; mk <<= 1)
#pragma unroll
                for (int r = 0; r < 16; ++r) ss[r] += __shfl_xor(ss[r], mk);
            LAS bf16_t* ost = (LAS bf16_t*)(lds + OST_OFF + lw * 8192);
            float gs[NDQ];
#pragma unroll
            for (int i = 0; i < NDQ; ++i) gs[i] = P.subln[i * 32 + r32] * ONE_M_LAMINIT;
#pragma unroll
            for (int r = 0; r < 16; ++r) { const float rn = __builtin_amdgcn_rsqf(ss[r] * (1.f / 128.f) + RMS_EPS);
#pragma unroll
                for (int i = 0; i < NDQ; ++i) ost[crow(r, hi) * 128 + i * 32 + r32] = (bf16_t)f2bf(o[i][r] * rn * gs[i]); }
            LDS_WAIT();
            bf16_t* Ob = P.O + (size_t)(qrow0 + 32 * lw) * 1024 + colb;
#pragma unroll
            for (int it = 0; it < 8; ++it) { const int id = it * 64 + lane, row = id >> 4, ch = id & 15;
                const u32x4 v = *(const LAS u32x4*)((const LAS unsigned char*)ost + row * 256 + ch * 16); *(u32x4*)(Ob + (size_t)row * 1024 + ch * 8) = v; }
        }
    } else {
        if (active) {
            LAS bf16_t* ost = (LAS bf16_t*)(lds + OST_OFF + wid * 4096);
#pragma unroll
            for (int r = 0; r < 16; ++r)
#pragma unroll
                for (int i = 0; i < NDQ; ++i) ost[crow(r, hi) * 64 + i * 32 + r32] = (bf16_t)f2bf(o[i][r] * rinv[r]);
            LDS_WAIT();
            bf16_t* Ob = P.O + (size_t)(qrow0 + 32 * lw) * 1024 + colb + 64 * g;
#pragma unroll
            for (int it = 0; it < 4; ++it) { const int id = it * 64 + lane, row = id >> 3, ch = id & 7;
                const u32x4 v = *(const LAS u32x4*)((const LAS unsigned char*)ost + row * 128 + ch * 16); *(u32x4*)(Ob + (size_t)row * 1024 + ch * 8) = v; }
        }
    }
    LDS_WAIT(); __syncthreads();
#undef ATT_DMA
#undef ATT_F32_SRC
#undef ATT_F32_LOAD
#undef ATT_F32_WRITE
#undef ATT_PK8
}
}

__device__ __forceinline__ void p0_transpose_item(const float* W, int K, int N, bf16_t* WT, LAS float* scr, int item, int lane, int mode,
                                                  const float* kscale, const float* kbias, float* pcs, float* pbw) {
    const int nblk = N / 32, kb = item / nblk, nb = item % nblk, k0 = 64 * kb, n0 = 32 * nb;
    float a_cs = 0.f, a_bw = 0.f;
#pragma unroll 8
    for (int i = 0; i < 32; ++i) { const int kk = 2 * i + (lane >> 5); float w = W[(size_t)(k0 + kk) * N + n0 + (lane & 31)];
        if (kscale) { a_bw += kbias[k0 + kk] * w; w *= kscale[k0 + kk]; a_cs += bfround(w); }
        scr[kk * 33 + (lane & 31)] = w; }
    float sc = 1.f; int drow0 = n0;
    if (mode == 3) { if (n0 < 1024 || (n0 >= 3072 && n0 < 4096)) sc = C2; }
    else if (mode == 1) drow0 = (n0 >> 7) * 256 + (n0 & 127);
    else if (mode == 2) drow0 = (n0 >> 7) * 256 + 128 + (n0 & 127);
    if (kscale) { a_cs += __shfl_xor(a_cs, 32); a_bw += __shfl_xor(a_bw, 32); if (lane < 32) { pcs[kb * NUG + drow0 + lane] = a_cs; pbw[kb * NUG + drow0 + lane] = a_bw; } }
    LDS_WAIT(); asm volatile("" ::: "memory");
    const int c = lane & 7;
#pragma unroll
    for (int j = 0; j < 4; ++j) { const int n = (lane >> 3) + 8 * j; const LAS float* s = scr + (8 * c) * 33 + n;
        u32x4 o; o.x = pk2(s[0 * 33] * sc, s[1 * 33] * sc); o.y = pk2(s[2 * 33] * sc, s[3 * 33] * sc); o.z = pk2(s[4 * 33] * sc, s[5 * 33] * sc); o.w = pk2(s[6 * 33] * sc, s[7 * 33] * sc);
        *(u32x4*)(WT + (size_t)(drow0 + n) * K + k0 + 8 * c) = o; }
    LDS_WAIT(); asm volatile("" ::: "memory");
}
__device__ __forceinline__ void cast_row_bf16(const float* xrow, bf16_t* orow, int lane) {
    const f32x4* xr = (const f32x4*)xrow + lane; u32x2* o8 = (u32x2*)orow + lane;
    f32x4 v[4];
#pragma unroll
    for (int j = 0; j < 4; ++j) v[j] = xr[64 * j];
#pragma unroll
    for (int j = 0; j < 4; ++j) { u32x2 w; w.x = pk2(v[j].x, v[j].y); w.y = pk2(v[j].z, v[j].w); o8[64 * j] = w; }
}
__device__ __forceinline__ float wave_sum(float v) {
#pragma unroll
    for (int o = 1; o < 64; o <<= 1) v += __shfl_xor(v, o);
    return v;
}

constexpr int NPH = 9;
__global__ void __launch_bounds__(512, 2) fwd(Args args) {
    extern __shared__ __attribute__((aligned(16))) unsigned char lds_raw[];
    LAS unsigned char* lds = (LAS unsigned char*)lds_raw;
    cg::grid_group grid = cg::this_grid();
    const int tid = threadIdx.x, lane = tid & 63, wave = __builtin_amdgcn_readfirstlane(tid >> 6);
    const int G = gridDim.x, bx = blockIdx.x, vcu = (G % 8 == 0) ? (bx % 8) * (G / 8) + bx / 8 : bx;
    unsigned char* ws = args.ws; float* out = args.out;
    const int lo = args.ph_lo, hi = args.ph_hi;
#define IN(k) (lo <= (k) && (k) < hi)
#define SEAM(k) do { if (IN(k) && IN((k) + 1)) grid.sync(); } while (0)

    if (IN(0)) {
        LAS float* scr = (LAS float*)(lds + wave * 16384);
        const int gw = vcu * 8 + wave, NGW = G * 8;
        float* pcs = (float*)(ws + WS_SMALL + SM_PCS); float* pbw = (float*)(ws + WS_SMALL + SM_PBW);
        constexpr int I_IN = 16 * 256, I_P = 16 * 32, I_UG = 16 * 88, I_DN = 44 * 32, NITEMS = I_IN + 3 * I_P + 2 * I_UG + I_DN;
        for (int it = gw; it < NITEMS; it += NGW) {
            int r = it;
            if (r < I_IN) { p0_transpose_item(args.in[8], 1024, NIN, (bf16_t*)(ws + WS_WIN), scr, r, lane, 3, nullptr, nullptr, nullptr, nullptr); continue; } r -= I_IN;
            if (r < I_P) { p0_transpose_item(args.in[15], 1024, 1024, (bf16_t*)(ws + WS_WPA), scr, r, lane, 0, nullptr, nullptr, nullptr, nullptr); continue; } r -= I_P;
            if (r < I_P) { p0_transpose_item(args.in[16], 1024, 1024, (bf16_t*)(ws + WS_WPB), scr, r, lane, 0, nullptr, nullptr, nullptr, nullptr); continue; } r -= I_P;
            if (r < I_P) { p0_transpose_item(args.in[17], 1024, 1024, (bf16_t*)(ws + WS_WOUT), scr, r, lane, 0, nullptr, nullptr, nullptr, nullptr); continue; } r -= I_P;
            if (r < I_UG) { p0_transpose_item(args.in[20], 1024, DFF, (bf16_t*)(ws + WS_WUG), scr, r, lane, 1, args.in[18], args.in[19], pcs, pbw); continue; } r -= I_UG;
            if (r < I_UG) { p0_transpose_item(args.in[21], 1024, DFF, (bf16_t*)(ws + WS_WUG), scr, r, lane, 2, args.in[18], args.in[19], pcs, pbw); continue; } r -= I_UG;
            p0_transpose_item(args.in[24], DFF, 1024, (bf16_t*)(ws + WS_WDN), scr, r, lane, 0, nullptr, nullptr, nullptr, nullptr);
        }
        bf16_t* XB = (bf16_t*)(ws + WS_XB);
        for (int m = gw; m < MT; m += NGW) cast_row_bf16(m < MP ? args.in[0] + (size_t)m * 1024 : args.in[1] + (size_t)(m - MP) * 1024, XB + (size_t)m * 1024, lane);
        if (bx == 0) {
            float* btab = (float*)(ws + WS_SMALL + SM_BTAB);
            for (int e = tid; e < 24 * 256; e += 512) { const int hh = e >> 8, i = e & 255; const int rel = (i == 255) ? -200 : i - 191; float val;
                if (hh < 8) { const int n = rel < 0 ? -rel : rel; int bk;
                    if (n < 8) bk = n; else { const int lg = (31 - __builtin_clz((unsigned)(n * n))) - 6; bk = 8 + lg; if (bk > 15) bk = 15; }
                    if (rel > 0) bk += 16; val = args.in[7][bk * 8 + hh]; }
                else { int idx = rel < -128 ? -128 : (rel > 128 ? 128 : rel); idx += 128; val = args.in[14][idx * 16 + (hh - 8)]; }
                btab[e] = val * LOG2E; }
            if (tid == 0) { float s1 = 0.f, s2 = 0.f; for (int i = 0; i < 64; ++i) { s1 += args.in[9][i] * args.in[10][i]; s2 += args.in[11][i] * args.in[12][i]; }
                *(float*)(ws + WS_SMALL + SM_LAM) = expf(s1) - expf(s2) + LAM_INIT; }
        }
    }
    SEAM(0);
    if (IN(1)) {
        for (int n = bx * 32 + tid; tid < 32 && n < NUG; n += G * 32) { const float* pcs = (const float*)(ws + WS_SMALL + SM_PCS); const float* pbw = (const float*)(ws + WS_SMALL + SM_PBW); float a = 0.f, c = 0.f;
            for (int k = 0; k < 16; ++k) { a += pcs[k * NUG + n]; c += pbw[k * NUG + n]; }
            ((float*)(ws + WS_SMALL + SM_CS))[n] = a; ((float*)(ws + WS_SMALL + SM_BW))[n] = c; }
        pg8::Gemm g; g.A0 = g.A1 = (const bf16_t*)(ws + WS_XB); g.B0 = g.B1 = (const bf16_t*)(ws + WS_WIN); g.K = 1024;
        pg8::OrderPlain S; S.init(MT, NIN, G, bx);
        pg8::EpiInProj E{ws, out};
        pg8::gemm_phase<pg8::EpiInProj, pg8::OrderPlain, true, true>(lds, g, S, E);
    }
    SEAM(1);
    if (IN(2)) {
        att::AttnP PA{(const bf16_t*)(ws + WS_QA), (const bf16_t*)(ws + WS_KA), (const bf16_t*)(ws + WS_VA), (bf16_t*)(ws + WS_QA), args.in[2], args.in[3],
                      (const float*)(ws + WS_SMALL + SM_BTAB), args.in[13], ld_relaxed((const float*)(ws + WS_SMALL + SM_LAM))};
        att::AttnP PB{(const bf16_t*)(ws + WS_QB), (const bf16_t*)(ws + WS_KB), (const bf16_t*)(ws + WS_VB), (bf16_t*)(ws + WS_QB), args.in[4], args.in[5],
                      (const float*)(ws + WS_SMALL + SM_BTAB), args.in[13], 0.f};
        for (int uid = vcu; uid < 4352; uid += G) {
            if (uid < 2048) { const int v = uid & 255, k = uid >> 8, bh = v >> 2, s = v & 3, i = 4 * s + (k >> 1); const int qb = (k & 1) ? i : 31 - i;
                att::attn_unit<true>(lds, PA, bh >> 3, bh & 7, qb, false); }
            else if (uid < 4096) { const int w = uid - 2048, v = w & 255, k = w >> 8, bh = v >> 2, s = v & 3; const int qb = 8 * s + k;
                att::attn_unit<false>(lds, PB, bh >> 3, bh & 7, qb, false); }
            else if (uid < 4224) { const int w = uid - 4096; att::attn_unit<true>(lds, PA, w >> 3, w & 7, 0, true); }
            else { const int w = uid - 4224; att::attn_unit<false>(lds, PB, w >> 3, w & 7, 0, true); }
        }
    }
    SEAM(2);
    if (IN(3)) {
        pg8::Gemm g; g.A0 = (const bf16_t*)(ws + WS_QA); g.A1 = (const bf16_t*)(ws + WS_QB); g.B0 = (const bf16_t*)(ws + WS_WPA); g.B1 = (const bf16_t*)(ws + WS_WPB); g.K = 1024;
        pg8::OrderPair S; S.init(MT, 1024, G, bx);
        pg8::EpiGate E{ws, out};
        pg8::gemm_phase<pg8::EpiGate, pg8::OrderPair, true, true>(lds, g, S, E);
    }
    SEAM(3);
    if (IN(4)) {
        pg8::Gemm g; g.A0 = g.A1 = (const bf16_t*)(ws + WS_MRG); g.B0 = g.B1 = (const bf16_t*)(ws + WS_WOUT); g.K = 1024;
        pg8::OrderPlain S; S.init(MT, 1024, G, bx);
        pg8::EpiZ E{args.in[0], args.in[1], ws, out, lds + PT_OFF};
        pg8::gemm_phase<pg8::EpiZ, pg8::OrderPlain, true, true>(lds, g, S, E);
    }
    SEAM(4);
    if (IN(5)) {
        pg8::Gemm g; g.A0 = g.A1 = (const bf16_t*)(ws + WS_ZB); g.B0 = g.B1 = (const bf16_t*)(ws + WS_WUG); g.K = 1024;
        pg8::OrderPlain S; S.init(MT, NUG, G, bx);
        pg8::EpiUG E{ws, out};
        pg8::gemm_phase<pg8::EpiUG, pg8::OrderPlain, true, true>(lds, g, S, E);
    }
    SEAM(5);
    if (IN(6)) {
        const bf16_t* U = (const bf16_t*)(ws + WS_U); bf16_t* Gt = (bf16_t*)(ws + WS_ACT);
        const float* cw = args.in[22]; const float* cb = args.in[23]; const float* cc = args.in[6];
        const long total = (long)MT * 352;
        for (long it = (long)vcu * 512 + tid; it < total; it += (long)G * 512) {
            const int row = (int)(it / 352), ch = (int)(it % 352), col = ch * 8;
            const bool samp = row >= MP; const int t = samp ? ((row - MP) & 63) : (row & 4095); const int seq = samp ? ((row - MP) >> 6) : 0;
            const u32x4 u0 = *(const u32x4*)(U + (size_t)row * DFF + col), gv = *(const u32x4*)(Gt + (size_t)row * DFF + col);
            float x0[8] = {bflo(u0.x), bfhi(u0.x), bflo(u0.y), bfhi(u0.y), bflo(u0.z), bfhi(u0.z), bflo(u0.w), bfhi(u0.w)};
            float x1[8], x2[8];
            if (t >= 1) { const u32x4 a = *(const u32x4*)(U + (size_t)(row - 1) * DFF + col); x1[0] = bflo(a.x); x1[1] = bfhi(a.x); x1[2] = bflo(a.y); x1[3] = bfhi(a.y); x1[4] = bflo(a.z); x1[5] = bfhi(a.z); x1[6] = bflo(a.w); x1[7] = bfhi(a.w); }
            else if (samp) { const float* p = cc + (size_t)(seq * 2 + 1) * DFF + col; _Pragma("unroll") for (int j = 0; j < 8; ++j) x1[j] = p[j]; }
            else { _Pragma("unroll") for (int j = 0; j < 8; ++j) x1[j] = 0.f; }
            if (t >= 2) { const u32x4 a = *(const u32x4*)(U + (size_t)(row - 2) * DFF + col); x2[0] = bflo(a.x); x2[1] = bfhi(a.x); x2[2] = bflo(a.y); x2[3] = bfhi(a.y); x2[4] = bflo(a.z); x2[5] = bfhi(a.z); x2[6] = bflo(a.w); x2[7] = bfhi(a.w); }
            else if (samp) { const float* p = cc + (size_t)(seq * 2 + t) * DFF + col; _Pragma("unroll") for (int j = 0; j < 8; ++j) x2[j] = p[j]; }
            else { _Pragma("unroll") for (int j = 0; j < 8; ++j) x2[j] = 0.f; }
            const float gg[8] = {bflo(gv.x), bfhi(gv.x), bflo(gv.y), bfhi(gv.y), bflo(gv.z), bfhi(gv.z), bflo(gv.w), bfhi(gv.w)};
            float a[8];
#pragma unroll
            for (int j = 0; j < 8; ++j) { const float uc = cb[col + j] + x2[j] * cw[col + j] + x1[j] * cw[DFF + col + j] + x0[j] * cw[2 * DFF + col + j]; a[j] = gelu_tanh(uc) * gg[j]; }
            u32x4 w; w.x = pk2(a[0], a[1]); w.y = pk2(a[2], a[3]); w.z = pk2(a[4], a[5]); w.w = pk2(a[6], a[7]);
            *(u32x4*)(Gt + (size_t)row * DFF + col) = w;
        }
    }
    SEAM(6);
    if (IN(7)) {
        pg8::Gemm g; g.A0 = g.A1 = (const bf16_t*)(ws + WS_ACT); g.B0 = g.B1 = (const bf16_t*)(ws + WS_WDN); g.K = DFF;
        pg8::OrderPlain S; S.init(MT, 1024, G, bx);
        pg8::EpiW E{ws, out, args.in[18], args.in[19]};
        pg8::gemm_phase<pg8::EpiW, pg8::OrderPlain, true, true>(lds, g, S, E);
    }
    SEAM(7);
    if (IN(8)) {
        const int gw = vcu * 8 + wave, NGW = G * 8;
        const f32x4* g2 = (const f32x4*)args.in[25] + lane; const f32x4* b2 = (const f32x4*)args.in[26] + lane;
        for (int m = gw; m < MT; m += NGW) {
            const float* src = m < MP ? out + O_Y_P + (size_t)m * 1024 : (const float*)(ws + WS_ZS) + (size_t)(m - MP) * 1024;
            float* dst = m < MP ? out + O_Y_P + (size_t)m * 1024 : out + O_Y_S + (size_t)(m - MP) * 1024;
            const f32x4* xr = (const f32x4*)src + lane; f32x4 v[4]; float s = 0.f;
#pragma unroll
            for (int j = 0; j < 4; ++j) { v[j] = xr[64 * j]; s += (v[j].x + v[j].y) + (v[j].z + v[j].w); }
            const float mean = wave_sum(s) * (1.f / 1024.f); float s2 = 0.f;
#pragma unroll
            for (int j = 0; j < 4; ++j) { v[j] = v[j] - mean; s2 += (v[j].x * v[j].x + v[j].y * v[j].y) + (v[j].z * v[j].z + v[j].w * v[j].w); }
            const float rstd = __builtin_amdgcn_rsqf(wave_sum(s2) * (1.f / 1024.f) + LN_EPS);
#pragma unroll
            for (int j = 0; j < 4; ++j) ((f32x4*)dst + lane)[64 * j] = v[j] * rstd * g2[64 * j] + b2[64 * j];
        }
    }
#undef IN
#undef SEAM
}

#ifndef MK_N_LAUNCHES
#define MK_N_LAUNCHES 1
#endif
extern "C" void kernel_launch(void* const* d_in, const int* in_sizes, int n_in, void* d_out, int out_size, void* d_ws, size_t ws_size, hipStream_t stream) {
    static int grid = 0;
    if (grid == 0) {
        if (n_in != 27 || (size_t)out_size != O_TOTAL || ws_size < WS_END) { fprintf(stderr, "kernel_launch: unexpected shapes: n_in %d out %d ws %zu\n", n_in, out_size, ws_size); grid = -1; return; }
        int dev = 0, cus = 0, per_cu = 0;
        if (hipGetDevice(&dev) != hipSuccess || hipDeviceGetAttribute(&cus, hipDeviceAttributeMultiprocessorCount, dev) != hipSuccess) { grid = -1; return; }
        if (hipFuncSetAttribute((const void*)fwd, hipFuncAttributeMaxDynamicSharedMemorySize, LDS_BYTES) != hipSuccess) { fprintf(stderr, "kernel_launch: hipFuncSetAttribute failed\n"); grid = -1; return; }
        if (hipOccupancyMaxActiveBlocksPerMultiprocessor(&per_cu, (const void*)fwd, 512, LDS_BYTES) != hipSuccess || per_cu < 1) { fprintf(stderr, "kernel_launch: occupancy query says %d\n", per_cu); per_cu = 1; }
        (void)hipGetLastError();
        grid = cus;
    }
    if (grid < 0) return;
    Args a{};
    for (int i = 0; i < 27; ++i) a.in[i] = (const float*)d_in[i];
    a.out = (float*)d_out; a.ws = (unsigned char*)d_ws;
#if MK_N_LAUNCHES == 1
    a.ph_lo = 0; a.ph_hi = NPH;
    { void* kargs[] = {&a}; hipError_t e = hipLaunchCooperativeKernel((const void*)fwd, dim3(grid), dim3(512), kargs, LDS_BYTES, stream);
      if (e != hipSuccess) fprintf(stderr, "kernel_launch: cooperative launch failed: %s (grid %d)\n", hipGetErrorString(e), grid); }
#else
    for (int p = 0; p < NPH; ++p) { a.ph_lo = p; a.ph_hi = p + 1; void* kargs[] = {&a};
        hipError_t e = hipLaunchCooperativeKernel((const void*)fwd, dim3(grid), dim3(512), kargs, LDS_BYTES, stream);
        if (e != hipSuccess) { fprintf(stderr, "kernel_launch: launch %d failed: %s\n", p, hipGetErrorString(e)); break; } }
#endif
}
```
